# Optimizing an MI355X kernel written in HIP

```python
import math, functools
import jax, jax.numpy as jnp
from jax import lax
import numpy as np

D_MODEL = 1024
BATCH = 8
SEQ = 4096
DEPTH = 1
DEC_BATCH = 16
DEC_SEQ = 16
PAST_LEN = 2048

CHUNK = 64
N_Q_HEADS = 16
N_KV_HEADS = 2
HEAD_DIM = 64
Q_PER_KV = N_Q_HEADS // N_KV_HEADS
ATTN_WIDTH = N_Q_HEADS * HEAD_DIM
KV_WIDTH = N_KV_HEADS * HEAD_DIM
WINDOW = 128
WINDOW_CHUNKS = WINDOW // CHUNK
GMLP_WIDTH = 1024
GMLP_GROUPS = 4
GMLP_GROUP_DIM = GMLP_WIDTH // GMLP_GROUPS
GMLP_CHUNK = 128
NUM_BUCKETS = 32
MAX_DISTANCE = 128
D_FF = 2816
EPS = 1e-6
NEG_INF = -1e30
IN_WIDTH = ATTN_WIDTH + 2 * KV_WIDTH + 2 * GMLP_WIDTH + 2 * D_MODEL
SPLIT_POINTS = (ATTN_WIDTH,
                ATTN_WIDTH + KV_WIDTH,
                ATTN_WIDTH + 2 * KV_WIDTH,
                ATTN_WIDTH + 2 * KV_WIDTH + GMLP_WIDTH,
                ATTN_WIDTH + 2 * KV_WIDTH + 2 * GMLP_WIDTH,
                ATTN_WIDTH + 2 * KV_WIDTH + 2 * GMLP_WIDTH + D_MODEL)

kernel_name = 'hybrid_swa_gmlp_streaming_step'


def rms_norm(x, g):
    xf = x.astype(jnp.float32)
    y = xf * lax.rsqrt(jnp.mean(xf * xf, axis=-1, keepdims=True) + EPS)
    return (y * g.astype(jnp.float32)).astype(x.dtype)


def layer_norm(x, g, b):
    xf = x.astype(jnp.float32)
    mu = jnp.mean(xf, axis=-1, keepdims=True)
    xc = xf - mu
    var = jnp.mean(xc * xc, axis=-1, keepdims=True)
    return (xc * lax.rsqrt(var + EPS) * g.astype(jnp.float32) + b.astype(jnp.float32)).astype(x.dtype)


def swiglu(x, w_gate, w_up, w_down):
    return (jax.nn.silu(x @ w_gate) * (x @ w_up)) @ w_down


def t5_bucket(rel):
    half = NUM_BUCKETS // 2
    max_exact = half // 2
    ret = jnp.where(rel > 0, half, 0)
    n = jnp.abs(rel)
    nf = jnp.maximum(n, 1).astype(jnp.float32)
    large = max_exact + (jnp.log(nf / max_exact) / math.log(MAX_DISTANCE / max_exact)
                         * (half - max_exact)).astype(jnp.int32)
    large = jnp.minimum(large, half - 1)
    return ret + jnp.where(n < max_exact, n, large)


def relative_bias(table, q_pos, k_pos):
    rel = k_pos[None, :] - q_pos[:, None]
    b = table[t5_bucket(rel)].astype(jnp.float32)
    b = b.reshape(q_pos.shape[0], k_pos.shape[0], N_KV_HEADS, Q_PER_KV)
    return jnp.transpose(b, (2, 3, 0, 1))


def sink_attention(q, k, v, bias, sinks, mask=None):
    s = jnp.einsum('...qhgd,...khd->...hgqk', q, k).astype(jnp.float32) * (HEAD_DIM ** -0.5) + bias
    if mask is not None:
        s = jnp.where(mask, s, NEG_INF)
    sink = sinks.astype(jnp.float32).reshape(N_KV_HEADS, Q_PER_KV)[:, :, None, None]
    sink_col = jnp.broadcast_to(sink, s.shape[:-1] + (1,))
    p = jax.nn.softmax(jnp.concatenate([s, sink_col], axis=-1), axis=-1)[..., :-1]
    return jnp.einsum('...hgqk,...khd->...qhgd', p.astype(v.dtype), v)


def window_attention_prompt(q, k, v, rel_table, sinks):
    B, S = q.shape[0], q.shape[1]
    n_chunks = S // CHUNK
    n_keys = (WINDOW_CHUNKS + 1) * CHUNK
    qb = q.reshape(B, n_chunks, CHUNK, N_KV_HEADS, Q_PER_KV, HEAD_DIM)

    def key_blocks(t):
        tp = jnp.pad(t.reshape(B, S, N_KV_HEADS, HEAD_DIM),
                     ((0, 0), (WINDOW_CHUNKS * CHUNK, 0), (0, 0), (0, 0)))
        tp = tp.reshape(B, n_chunks + WINDOW_CHUNKS, CHUNK, N_KV_HEADS, HEAD_DIM)
        return jnp.concatenate([tp[:, i:i + n_chunks] for i in range(WINDOW_CHUNKS + 1)], axis=2)

    kb, vb = key_blocks(k), key_blocks(v)
    key_chunk = jnp.arange(n_chunks)[:, None] + jnp.arange(n_keys)[None, :] // CHUNK - WINDOW_CHUNKS
    mask = (key_chunk >= 0)[None, :, None, None, None, :]
    bias = relative_bias(rel_table, jnp.arange(CHUNK), jnp.arange(n_keys) - WINDOW_CHUNKS * CHUNK)
    o = sink_attention(qb, kb, vb, bias, sinks, mask)
    return o.reshape(B, S, ATTN_WIDTH)


def spatial_gate(u, vn, w_s, b_s):
    L = u.shape[2]
    blk = jnp.arange(L) // CHUNK
    mask = blk[None, :] <= blk[:, None]
    w = jnp.where(mask[None], w_s[:, :L, :L], 0).astype(vn.dtype)
    bias = jnp.transpose(b_s[:, :L])[:, :, None].astype(vn.dtype)
    return u * (jnp.einsum('gij,bcjgd->bcigd', w, vn) + bias)


def prompt_mixer(q, k, v, u, vn, rel_table, sinks, w_s, b_s):
    B, S = q.shape[0], q.shape[1]
    attn = window_attention_prompt(q, k, v, rel_table, sinks)
    nb = S // GMLP_CHUNK
    shp = (B, nb, GMLP_CHUNK, GMLP_GROUPS, GMLP_GROUP_DIM)
    gm = spatial_gate(u.reshape(shp), vn.reshape(shp), w_s, b_s).reshape(B, S, GMLP_WIDTH)
    kw = k.reshape(B, S, N_KV_HEADS, HEAD_DIM)[:, S - WINDOW:]
    vw = v.reshape(B, S, N_KV_HEADS, HEAD_DIM)[:, S - WINDOW:]
    return attn, gm, (kw, vw)


def sample_mixer(q, k, v, u, vn, cache_k, cache_v, rel_table, sinks, w_s, b_s):
    Bd, Q = q.shape[0], q.shape[1]
    qh = q.reshape(Bd, Q, N_KV_HEADS, Q_PER_KV, HEAD_DIM)
    kh = k.reshape(Bd, Q, N_KV_HEADS, HEAD_DIM)
    vh = v.reshape(Bd, Q, N_KV_HEADS, HEAD_DIM)
    n_cache = cache_k.shape[1]
    k_all = jnp.concatenate([cache_k.astype(kh.dtype), kh], axis=1)
    v_all = jnp.concatenate([cache_v.astype(vh.dtype), vh], axis=1)
    bias = relative_bias(rel_table, jnp.arange(Q), jnp.arange(n_cache + Q) - n_cache)
    attn = sink_attention(qh, k_all, v_all, bias, sinks).reshape(Bd, Q, ATTN_WIDTH)
    shp = (Bd, 1, Q, GMLP_GROUPS, GMLP_GROUP_DIM)
    gm = spatial_gate(u.reshape(shp), vn.reshape(shp), w_s, b_s).reshape(Bd, Q, GMLP_WIDTH)
    return attn, gm, (kh, vh, vn)


def layer_forward(x, mixer, norm_g, f1_g, f1_u, f1_d, w_in, ln_g, ln_b,
                  w_ba, w_bg, w_o, f2_g, f2_u, f2_d):
    x = x + 0.5 * rms_norm(swiglu(rms_norm(x, norm_g[0]), f1_g, f1_u, f1_d), norm_g[1])
    h = rms_norm(x, norm_g[2])
    q, k, v, u, gv, ga, gb = jnp.split(h @ w_in, SPLIT_POINTS, axis=-1)
    u = jax.nn.gelu(u, approximate=False)
    vn = layer_norm(jax.nn.gelu(gv, approximate=False), ln_g, ln_b)
    attn, gm, state = mixer(q, k, v, u, vn)
    merged = jax.nn.sigmoid(ga) * (attn @ w_ba) + jax.nn.sigmoid(gb) * (gm @ w_bg)
    x = x + rms_norm(merged @ w_o, norm_g[3])
    x = x + 0.5 * rms_norm(swiglu(rms_norm(x, norm_g[4]), f2_g, f2_u, f2_d), norm_g[5])
    return x, state


def setup_inputs(seed: int = 0) -> dict:
    key = jax.random.key(seed)
    ks = jax.random.split(key, 24)
    f32 = jnp.float32

    def nrm(k, shape, scale):
        return jax.random.normal(k, shape, f32) * scale

    n_cache = min(WINDOW, PAST_LEN)
    return {
        'x_prompt': nrm(ks[0], (BATCH, SEQ, D_MODEL), 1.0),
        'x_sample': nrm(ks[1], (DEC_BATCH, DEC_SEQ, D_MODEL), 1.0),
        'cache_win_k': nrm(ks[2], (DEPTH, DEC_BATCH, n_cache, N_KV_HEADS, HEAD_DIM), 1.0),
        'cache_win_v': nrm(ks[3], (DEPTH, DEC_BATCH, n_cache, N_KV_HEADS, HEAD_DIM), 1.0),
        'rel_bias_table': nrm(ks[4], (NUM_BUCKETS, N_Q_HEADS), 0.5),
        'norm_gains': 1.0 + nrm(ks[5], (DEPTH, 6, D_MODEL), 0.05),
        'ffn1_w_gate': nrm(ks[6], (DEPTH, D_MODEL, D_FF), D_MODEL ** -0.5),
        'ffn1_w_up': nrm(ks[7], (DEPTH, D_MODEL, D_FF), D_MODEL ** -0.5),
        'ffn1_w_down': nrm(ks[8], (DEPTH, D_FF, D_MODEL), D_FF ** -0.5),
        'w_in': nrm(ks[9], (DEPTH, D_MODEL, IN_WIDTH), D_MODEL ** -0.5),
        'attn_sinks': nrm(ks[10], (DEPTH, N_Q_HEADS), 0.5),
        'gmlp_ln_g': 1.0 + nrm(ks[11], (DEPTH, GMLP_WIDTH), 0.05),
        'gmlp_ln_b': nrm(ks[12], (DEPTH, GMLP_WIDTH), 0.02),
        'gmlp_w_s': nrm(ks[13], (DEPTH, GMLP_GROUPS, GMLP_CHUNK, GMLP_CHUNK), GMLP_CHUNK ** -0.5),
        'gmlp_b_s': 1.0 + nrm(ks[14], (DEPTH, GMLP_GROUPS, GMLP_CHUNK), 0.05),
        'w_branch_attn': nrm(ks[15], (DEPTH, ATTN_WIDTH, D_MODEL), ATTN_WIDTH ** -0.5),
        'w_branch_gmlp': nrm(ks[16], (DEPTH, GMLP_WIDTH, D_MODEL), GMLP_WIDTH ** -0.5),
        'w_out': nrm(ks[17], (DEPTH, D_MODEL, D_MODEL), D_MODEL ** -0.5),
        'ffn2_w_gate': nrm(ks[18], (DEPTH, D_MODEL, D_FF), D_MODEL ** -0.5),
        'ffn2_w_up': nrm(ks[19], (DEPTH, D_MODEL, D_FF), D_MODEL ** -0.5),
        'ffn2_w_down': nrm(ks[20], (DEPTH, D_FF, D_MODEL), D_FF ** -0.5),
    }


def reference(x_prompt, x_sample, cache_win_k, cache_win_v, rel_bias_table, norm_gains,
              ffn1_w_gate, ffn1_w_up, ffn1_w_down, w_in, attn_sinks, gmlp_ln_g, gmlp_ln_b,
              gmlp_w_s, gmlp_b_s, w_branch_attn, w_branch_gmlp, w_out,
              ffn2_w_gate, ffn2_w_up, ffn2_w_down):
    xp, xs = x_prompt, x_sample
    kp_list, vp_list, ks_list, vs_list, gs_list = [], [], [], [], []
    for l in range(DEPTH):
        shared = (norm_gains[l], ffn1_w_gate[l], ffn1_w_up[l], ffn1_w_down[l], w_in[l],
                  gmlp_ln_g[l], gmlp_ln_b[l], w_branch_attn[l], w_branch_gmlp[l], w_out[l],
                  ffn2_w_gate[l], ffn2_w_up[l], ffn2_w_down[l])
        p_mix = functools.partial(prompt_mixer, rel_table=rel_bias_table, sinks=attn_sinks[l],
                                  w_s=gmlp_w_s[l], b_s=gmlp_b_s[l])
        s_mix = functools.partial(sample_mixer, cache_k=cache_win_k[l], cache_v=cache_win_v[l],
                                  rel_table=rel_bias_table, sinks=attn_sinks[l],
                                  w_s=gmlp_w_s[l], b_s=gmlp_b_s[l])
        xp, (kw, vw) = layer_forward(xp, p_mix, *shared)
        xs, (kn, vn_rows, gv_rows) = layer_forward(xs, s_mix, *shared)
        kp_list.append(kw)
        vp_list.append(vw)
        ks_list.append(kn)
        vs_list.append(vn_rows)
        gs_list.append(gv_rows)
    win_k_prompt = jnp.stack(kp_list, axis=0)
    win_v_prompt = jnp.stack(vp_list, axis=0)
    new_k_sample = jnp.stack(ks_list, axis=0)
    new_v_sample = jnp.stack(vs_list, axis=0)
    gmlp_v_sample = jnp.stack(gs_list, axis=0)
    return (xp, xs, win_k_prompt, win_v_prompt, new_k_sample, new_v_sample, gmlp_v_sample)
```

```cpp
#include <hip/hip_runtime.h>
#include <cstdio>
#include <cstdint>

#ifndef MK_N_LAUNCHES
#define MK_N_LAUNCHES 13
#endif

constexpr int D = 1024, DFF = 2816, NIN = 5376, NFF2 = 2 * DFF;
constexpr int MP = 32768, MS = 256, M = MP + MS;
constexpr int SEQ = 4096, NB = 8, NBD = 16, DSEQ = 16;
constexpr float EPS = 1e-6f;
constexpr float LOG2E = 1.4426950408889634f;
constexpr float QSCALE = 0.125f * LOG2E;
constexpr size_t O_Y = 0, O_WK = (size_t)M * D, O_WV = O_WK + 131072, O_NK = O_WV + 131072, O_NV = O_NK + 32768, O_GV = O_NV + 32768, O_END = O_GV + 262144;

namespace pg8 {
#define PG8_LAS __attribute__((address_space(3)))
typedef unsigned short bf16_t;
typedef short bf16x8 __attribute__((ext_vector_type(8)));
typedef float f32x4 __attribute__((ext_vector_type(4)));
typedef float f32x2 __attribute__((ext_vector_type(2)));
typedef unsigned u32x4 __attribute__((ext_vector_type(4)));
typedef unsigned u32x2 __attribute__((ext_vector_type(2)));
constexpr int BM = 256, BK = 64, HALF = 128, HTB = HALF * BK * 2, STAGE_BYTES = 8 * HTB, NXCD = 8, WGM = 8;

__host__ __device__ __forceinline__ int lds_byte(int r, int c) { const int st = (r >> 4) * 2 + (c >> 5), rr = r & 15, cc = c & 31, ob = rr * 64 + cc * 2; return st * 1024 + (ob ^ (((ob >> 9) & 1) << 5)); }
__host__ __device__ __forceinline__ void stage_rc(int b, int& R, int& C) { const int st = b / 1024, sb = b % 1024, swz = sb ^ (((sb >> 9) & 1) << 5); R = (st >> 1) * 16 + swz / 64; C = (st & 1) * 32 + (swz % 64) / 2; }
__host__ __device__ __forceinline__ int perm32(int rho) { const int n = rho >> 4, i = rho & 15; return 8 * (i >> 2) + 4 * n + (i & 3); }

struct Unit { int pm, pn, part; };
struct Gemm { const bf16_t* A0; const bf16_t* B0; const bf16_t* A1; const bf16_t* B1; int K; };

template <int PARTS> struct StaticOrder {
    int nM, nN, nwg, G, c;
    __device__ void init(int M_, int N_, int G_, int c_) { nM = M_ / BM; nN = N_ / BM; nwg = nM * nN; G = G_; c = c_; }
    __device__ bool next(int i, Unit& u) const {
        const long L = (long)(i / PARTS) * G + c; if (L >= nwg) return false;
        int wgid = (int)L; { const int q = nwg / NXCD, r = nwg % NXCD, xcd = wgid % NXCD, off = wgid / NXCD; wgid = (xcd < r ? xcd * (q + 1) : r * (q + 1) + (xcd - r) * q) + off; }
        const int nig = WGM * nN, gid = wgid / nig, fm = gid * WGM, gsz = (nM - fm) < WGM ? (nM - fm) : WGM;
        u.pm = fm + ((wgid % nig) % gsz); u.pn = (wgid % nig) / gsz; u.part = i % PARTS; return true;
    }
};

__device__ __forceinline__ unsigned cvt_pk_bf16(float lo, float hi) { unsigned r; asm volatile("v_cvt_pk_bf16_f32 %0, %1, %2" : "=v"(r) : "v"(lo), "v"(hi)); return r; }
__device__ __forceinline__ float bf_lo(unsigned w) { return __uint_as_float(w << 16); }
__device__ __forceinline__ float bf_hi(unsigned w) { return __uint_as_float(w & 0xffff0000u); }
__device__ __forceinline__ f32x2 gelu_pk(f32x2 v) {
    const f32x2 av = __builtin_elementwise_abs(v), d = av * 0.2316418882f + 1.0f;
    f32x2 t; t.x = __builtin_amdgcn_rcpf(d.x); t.y = __builtin_amdgcn_rcpf(d.y);
    f32x2 q = t * 0.5307027145f + (-0.7265760135f); q = q * t + 0.7107068705f; q = q * t + (-0.142248368f); q = q * t + 0.127414796f; q = q * t;
    const f32x2 s = (v * v) * (-0.72134752044f);
    f32x2 e; e.x = __builtin_amdgcn_exp2f(s.x); e.y = __builtin_amdgcn_exp2f(s.y);
    const f32x2 m = v * (q * e), r = v - m;
    f32x2 o; o.x = v.x < 0.f ? m.x : r.x; o.y = v.y < 0.f ? m.y : r.y; return o;
}
__device__ __forceinline__ float sigmoidf_(float z) { return __builtin_amdgcn_rcpf(1.0f + __builtin_amdgcn_exp2f(-z * LOG2E)); }
template <int ACT> __device__ __forceinline__ f32x4 act4(f32x4 v) {
    if (ACT == 1) { f32x2 a = gelu_pk((f32x2){v[0], v[1]}), b = gelu_pk((f32x2){v[2], v[3]}); return (f32x4){a.x, a.y, b.x, b.y}; }
    if (ACT == 2) { return (f32x4){sigmoidf_(v[0]), sigmoidf_(v[1]), sigmoidf_(v[2]), sigmoidf_(v[3])}; }
    return v;
}

typedef f32x4 Acc[2][2][4][2];

struct EpiF32 {
    static constexpr bool PERM = false, CHAIN = false;
    float* C; int ldc;
    __device__ __forceinline__ void operator()(Acc& acc, const Unit& u, int wr, int wc, int fr, int fq) const {
        const int row0 = u.pm * BM + wr * 64 + fr, col0 = u.pn * BM + wc * 32 + 4 * fq;
#pragma unroll
        for (int ai = 0; ai < 2; ++ai)
#pragma unroll
            for (int m = 0; m < 4; ++m) { float* rowp = C + (size_t)(row0 + ai * HALF + m * 16) * ldc + col0;
#pragma unroll
                for (int bj = 0; bj < 2; ++bj)
#pragma unroll
                    for (int n = 0; n < 2; ++n) *(f32x4*)(rowp + bj * HALF + n * 16) = acc[ai][bj][m][n]; }
    }
};

struct EpiSwiGLU {
    static constexpr bool PERM = true, CHAIN = false;
    bf16_t* H; const float* rs;
    __device__ __forceinline__ void operator()(Acc& acc, const Unit& u, int wr, int wc, int fr, int fq) const {
        const int row0 = u.pm * BM + wr * 64 + fr, col0 = u.pn * HALF + wc * 32 + 8 * fq;
#pragma unroll
        for (int ai = 0; ai < 2; ++ai)
#pragma unroll
            for (int m = 0; m < 4; ++m) { const int row = row0 + ai * HALF + m * 16; const float r = rs[row];
                u32x4 w; unsigned ww[4];
#pragma unroll
                for (int n = 0; n < 2; ++n) { const f32x4 g = acc[ai][0][m][n] * r, up = acc[ai][1][m][n] * r; float h[4];
#pragma unroll
                    for (int e = 0; e < 4; ++e) h[e] = g[e] * sigmoidf_(g[e]) * up[e];
                    ww[2 * n] = cvt_pk_bf16(h[0], h[1]); ww[2 * n + 1] = cvt_pk_bf16(h[2], h[3]); }
                w.x = ww[0]; w.y = ww[1]; w.z = ww[2]; w.w = ww[3];
                *(u32x4*)(H + (size_t)row * DFF + col0) = w; }
    }
};

struct EpiWin {
    static constexpr bool PERM = true, CHAIN = false;
    bf16_t *q, *kb, *vb, *ub, *gv, *sa, *sb, *kvsk, *kvsv; const float* rs; float* out;
    template <int ACT> __device__ __forceinline__ void tile(Acc& acc, bf16_t* base, int colt, float sc, const Unit& u, int wr, int wc, int fr, int fq) const {
        const int row0 = u.pm * BM + wr * 64 + fr, col0 = colt + wc * 32 + 8 * fq;
#pragma unroll
        for (int ai = 0; ai < 2; ++ai)
#pragma unroll
            for (int m = 0; m < 4; ++m) { const int row = row0 + ai * HALF + m * 16; const float r = rs[row] * sc; bf16_t* rowp = base + (size_t)row * D + col0;
#pragma unroll
                for (int bj = 0; bj < 2; ++bj) { const f32x4 v0 = act4<ACT>(acc[ai][bj][m][0] * r), v1 = act4<ACT>(acc[ai][bj][m][1] * r);
                    u32x4 w; w.x = cvt_pk_bf16(v0[0], v0[1]); w.y = cvt_pk_bf16(v0[2], v0[3]); w.z = cvt_pk_bf16(v1[0], v1[1]); w.w = cvt_pk_bf16(v1[2], v1[3]);
                    *(u32x4*)(rowp + bj * HALF) = w; } }
    }
    __device__ __forceinline__ void kvtile(Acc& acc, const Unit& u, int wr, int wc, int fr, int fq) const {
        const int row0 = u.pm * BM + wr * 64 + fr, col0 = wc * 32 + 8 * fq;
#pragma unroll
        for (int ai = 0; ai < 2; ++ai)
#pragma unroll
            for (int m = 0; m < 4; ++m) { const int row = row0 + ai * HALF + m * 16; const float r = rs[row];
#pragma unroll
                for (int bj = 0; bj < 2; ++bj) { const f32x4 v0 = acc[ai][bj][m][0] * r, v1 = acc[ai][bj][m][1] * r;
                    u32x4 w; w.x = cvt_pk_bf16(v0[0], v0[1]); w.y = cvt_pk_bf16(v0[2], v0[3]); w.z = cvt_pk_bf16(v1[0], v1[1]); w.w = cvt_pk_bf16(v1[2], v1[3]);
                    *(u32x4*)((bj ? vb : kb) + (size_t)row * 128 + col0) = w;
                    if (row >= MP) {
                        const int rsamp = row - MP; float* o = out + (bj ? O_NV : O_NK) + (size_t)rsamp * 128 + col0;
                        *(f32x4*)o = v0; *(f32x4*)(o + 4) = v1;
                        *(u32x4*)((bj ? kvsv : kvsk) + ((size_t)(rsamp >> 4) * 192 + 128 + (rsamp & 15)) * 128 + col0) = w;
                    } else { const int s = row & (SEQ - 1);
                        if (s >= SEQ - 128) { float* o = out + (bj ? O_WV : O_WK) + ((size_t)(row >> 12) * 128 + (s - (SEQ - 128))) * 128 + col0; *(f32x4*)o = v0; *(f32x4*)(o + 4) = v1; } }
                } }
    }
    __device__ __forceinline__ void operator()(Acc& acc, const Unit& u, int wr, int wc, int fr, int fq) const {
        const int pn = u.pn;
        if (pn < 4) tile<0>(acc, q, pn * 256, QSCALE, u, wr, wc, fr, fq);
        else if (pn == 4) kvtile(acc, u, wr, wc, fr, fq);
        else if (pn < 9) tile<1>(acc, ub, (pn - 5) * 256, 1.f, u, wr, wc, fr, fq);
        else if (pn < 13) tile<1>(acc, gv, (pn - 9) * 256, 1.f, u, wr, wc, fr, fq);
        else if (pn < 17) tile<2>(acc, sa, (pn - 13) * 256, 1.f, u, wr, wc, fr, fq);
        else tile<2>(acc, sb, (pn - 17) * 256, 1.f, u, wr, wc, fr, fq);
    }
};

struct EpiBranch {
    static constexpr bool PERM = true, CHAIN = true;
    bf16_t* sa; const bf16_t* sb;
    __device__ __forceinline__ void operator()(Acc& acc, const Unit& u, int wr, int wc, int fr, int fq) const {
        const int row0 = u.pm * BM + wr * 64 + fr, col0 = u.pn * BM + wc * 32 + 8 * fq;
#pragma unroll
        for (int ai = 0; ai < 2; ++ai)
#pragma unroll
            for (int m = 0; m < 4; ++m) { const size_t off = (size_t)(row0 + ai * HALF + m * 16) * D + col0;
#pragma unroll
                for (int bj = 0; bj < 2; ++bj) {
                    const u32x4 wb = *(const u32x4*)(sb + off + bj * HALF);
                    const float b[8] = {bf_lo(wb.x), bf_hi(wb.x), bf_lo(wb.y), bf_hi(wb.y), bf_lo(wb.z), bf_hi(wb.z), bf_lo(wb.w), bf_hi(wb.w)};
                    if (u.part == 0) {
                        const u32x4 wa = *(const u32x4*)(sa + off + bj * HALF);
                        const float a[8] = {bf_lo(wa.x), bf_hi(wa.x), bf_lo(wa.y), bf_hi(wa.y), bf_lo(wa.z), bf_hi(wa.z), bf_lo(wa.w), bf_hi(wa.w)};
#pragma unroll
                        for (int e = 0; e < 4; ++e) { acc[ai][bj][m][0][e] *= a[e] * __builtin_amdgcn_rcpf(fmaxf(b[e], 1e-30f)); acc[ai][bj][m][1][e] *= a[4 + e] * __builtin_amdgcn_rcpf(fmaxf(b[4 + e], 1e-30f)); }
                    } else {
                        f32x4 v0 = acc[ai][bj][m][0], v1 = acc[ai][bj][m][1];
#pragma unroll
                        for (int e = 0; e < 4; ++e) { v0[e] *= b[e]; v1[e] *= b[4 + e]; }
                        u32x4 w; w.x = cvt_pk_bf16(v0[0], v0[1]); w.y = cvt_pk_bf16(v0[2], v0[3]); w.z = cvt_pk_bf16(v1[0], v1[1]); w.w = cvt_pk_bf16(v1[2], v1[3]);
                        *(u32x4*)(sa + off + bj * HALF) = w;
                    } } }
    }
};

template <class Epi, class Sched>
__device__ __forceinline__ void gemm_phase(PG8_LAS unsigned char* lds, const Gemm g, const Sched& S, const Epi& E) {
    const int tid = threadIdx.x, wid = __builtin_amdgcn_readfirstlane(tid >> 6), lane = tid & 63, wr = wid >> 2, wc = wid & 3, fr = lane & 15, fq = lane >> 4;
    const int K = g.K, nt = K / BK;
    unsigned voffA[2], voffB[2];
#pragma unroll
    for (int i = 0; i < 2; ++i) { int R, C; stage_rc(tid * 16 + i * 8192, R, C); const int Rb = Epi::PERM ? ((R & ~31) + perm32(R & 31)) : R;
        voffA[i] = (unsigned)(R * K + C) * 2u; voffB[i] = (unsigned)(Rb * K + C) * 2u; }
    const size_t kstep = (size_t)(BK * 2);
    const size_t hstep = (size_t)HALF * K * 2;
    const size_t tstep = 2 * hstep;
    const unsigned ldsw = (unsigned)wid * 1024u;
    const int aoff = lds_byte(wr * 64 + fr, fq * 8), boff = lds_byte(wc * 32 + fr, fq * 8);
#define PG8_SA(b, h) (((b) * 2 + (h)) * HTB)
#define PG8_SB(b, h) ((4 + (b) * 2 + (h)) * HTB)
#define PG8_STAGE(bufoff, gbase, voff) do { _Pragma("unroll") for (int _i = 0; _i < 2; ++_i) \
        __builtin_amdgcn_global_load_lds((const unsigned*)((const char*)(gbase) + (voff)[_i]), (PG8_LAS unsigned*)(lds + (bufoff) + ldsw + _i * 8192), 16, 0, 0); } while (0)
#define PG8_LDA(dst, b, h) do { _Pragma("unroll") for (int m = 0; m < 4; ++m) _Pragma("unroll") for (int k = 0; k < 2; ++k) dst[m][k] = *(const PG8_LAS bf16x8*)(lds + PG8_SA(b, h) + aoff + m * 2048 + k * 1024); } while (0)
#define PG8_LDB(dst, b, h) do { _Pragma("unroll") for (int n = 0; n < 2; ++n) _Pragma("unroll") for (int k = 0; k < 2; ++k) dst[n][k] = *(const PG8_LAS bf16x8*)(lds + PG8_SB(b, h) + boff + n * 2048 + k * 1024); } while (0)
#define PG8_MMA(ai, bj, At, Bt) do { __builtin_amdgcn_s_setprio(1); _Pragma("unroll") for (int m = 0; m < 4; ++m) _Pragma("unroll") for (int n = 0; n < 2; ++n) _Pragma("unroll") for (int k = 0; k < 2; ++k) \
        acc[ai][bj][m][n] = __builtin_amdgcn_mfma_f32_16x16x32_bf16(Bt[n][k], At[m][k], acc[ai][bj][m][n], 0, 0, 0); __builtin_amdgcn_s_setprio(0); } while (0)
#define PG8_WAIT_V(n) asm volatile("s_waitcnt vmcnt(" #n ")" ::: "memory")
#define PG8_WAIT_L(n) asm volatile("s_waitcnt lgkmcnt(" #n ")" ::: "memory")
#define PG8_BAR __builtin_amdgcn_s_barrier()
#define PG8_SCHED __builtin_amdgcn_sched_barrier(0)
    Unit cur, nxt; int ui = 0;
    if (!S.next(0, cur)) return;
    Acc acc;
#pragma unroll
    for (int a = 0; a < 2; ++a)
#pragma unroll
        for (int b = 0; b < 2; ++b)
#pragma unroll
            for (int m = 0; m < 4; ++m)
#pragma unroll
                for (int n = 0; n < 2; ++n) acc[a][b][m][n] = (f32x4){0.f, 0.f, 0.f, 0.f};
    bf16x8 At[4][2], B0[2][2], B1[2][2];
    const char* cA = (const char*)(cur.part ? g.A1 : g.A0) + (size_t)cur.pm * tstep; const char* cB = (const char*)(cur.part ? g.B1 : g.B0) + (size_t)cur.pn * tstep;
    PG8_STAGE(PG8_SB(0, 0), cB, voffB); PG8_STAGE(PG8_SB(0, 1), cB + hstep, voffB); PG8_STAGE(PG8_SA(0, 0), cA, voffA); PG8_STAGE(PG8_SA(0, 1), cA + hstep, voffA);
    if (wr == 1) PG8_BAR;
    PG8_WAIT_V(2); PG8_BAR;
    PG8_STAGE(PG8_SB(1, 0), cB + kstep, voffB); PG8_STAGE(PG8_SA(1, 0), cA + kstep, voffA); PG8_STAGE(PG8_SB(1, 1), cB + hstep + kstep, voffB);
    PG8_WAIT_V(6); PG8_BAR;
    for (;;) {
        const bool has_next = S.next(ui + 1, nxt);
        const char* nA = has_next ? (const char*)(nxt.part ? g.A1 : g.A0) + (size_t)nxt.pm * tstep : cA; const char* nB = has_next ? (const char*)(nxt.part ? g.B1 : g.B0) + (size_t)nxt.pn * tstep : cB;
        for (int t = 0; t < nt; t += 2) {
            const bool last = (t == nt - 2);
            const char* a1 = cA + (size_t)(t + 1) * kstep;
            const char* a2 = last ? nA : cA + (size_t)(t + 2) * kstep; const char* b2 = last ? nB : cB + (size_t)(t + 2) * kstep;
            const char* a3 = a2 + kstep; const char* b3 = b2 + kstep;
            PG8_LDB(B0, 0, 0); PG8_LDB(B1, 0, 1); PG8_SCHED; PG8_LDA(At, 0, 0); PG8_STAGE(PG8_SA(1, 1), a1 + hstep, voffA);
            PG8_WAIT_V(8); PG8_WAIT_L(0); PG8_BAR; PG8_MMA(0, 0, At, B0); PG8_MMA(0, 1, At, B1); PG8_BAR; PG8_SCHED;
            PG8_LDA(At, 0, 1); PG8_STAGE(PG8_SB(0, 0), b2, voffB); PG8_STAGE(PG8_SB(0, 1), b2 + hstep, voffB); PG8_STAGE(PG8_SA(0, 0), a2, voffA);
            PG8_WAIT_V(8); PG8_WAIT_L(0); PG8_BAR; PG8_MMA(1, 0, At, B0); PG8_MMA(1, 1, At, B1); PG8_BAR; PG8_SCHED;
            PG8_LDB(B0, 1, 0); PG8_LDB(B1, 1, 1); PG8_SCHED; PG8_LDA(At, 1, 0); PG8_STAGE(PG8_SA(0, 1), a2 + hstep, voffA);
            PG8_WAIT_V(8); PG8_WAIT_L(0); PG8_BAR; PG8_MMA(0, 0, At, B0); PG8_MMA(0, 1, At, B1); PG8_BAR; PG8_SCHED;
            PG8_LDA(At, 1, 1); PG8_STAGE(PG8_SB(1, 0), b3, voffB); PG8_STAGE(PG8_SB(1, 1), b3 + hstep, voffB); PG8_STAGE(PG8_SA(1, 0), a3, voffA);
            PG8_WAIT_V(8); PG8_WAIT_L(0); PG8_BAR; PG8_MMA(1, 0, At, B0); PG8_MMA(1, 1, At, B1); PG8_BAR; PG8_SCHED;
        }
        if (wr == 0) PG8_BAR;
        E(acc, cur, wr, wc, fr, fq);
        if (!has_next) break;
        if (!(Epi::CHAIN && cur.part == 0)) {
#pragma unroll
            for (int a = 0; a < 2; ++a)
#pragma unroll
                for (int b = 0; b < 2; ++b)
#pragma unroll
                    for (int m = 0; m < 4; ++m)
#pragma unroll
                        for (int n = 0; n < 2; ++n) acc[a][b][m][n] = (f32x4){0.f, 0.f, 0.f, 0.f};
        }
        cur = nxt; cA = nA; cB = nB; ++ui;
        if (wr == 1) PG8_BAR;
    }
    PG8_WAIT_V(0);
    PG8_BAR;
#undef PG8_SA
#undef PG8_SB
#undef PG8_STAGE
#undef PG8_LDA
#undef PG8_LDB
#undef PG8_MMA
#undef PG8_WAIT_V
#undef PG8_WAIT_L
#undef PG8_BAR
#undef PG8_SCHED
}
}

constexpr int NWAVES = 8;
constexpr int N_LAUNCHES = MK_N_LAUNCHES;
constexpr int PER_PHASE = 13;

constexpr size_t MiB = 1u << 20, KiB = 1024;
constexpr size_t WS_CTL = 0, CTL_ZERO_BYTES = 64 * KiB;
constexpr size_t WS_TAB = 1 * MiB;
constexpr size_t TB_BIAS = WS_TAB, TB_SINK = WS_TAB + 16 * KiB, TB_WSB = WS_TAB + 64 * KiB, TB_RS0 = WS_TAB + 256 * KiB, TB_RS2 = WS_TAB + 448 * KiB, TB_RS4 = WS_TAB + 640 * KiB;
constexpr size_t WS_KVSK = 2 * MiB, WS_KVSV = WS_KVSK + 768 * KiB;
constexpr size_t WS_W1 = 4 * MiB, WS_WD1 = 15 * MiB, WS_WIN = 21 * MiB, WS_WBA = 32 * MiB, WS_WBG = 34 * MiB, WS_WO = 36 * MiB, WS_W2 = 38 * MiB, WS_WD2 = 49 * MiB;
constexpr size_t WS_K = 55 * MiB, WS_V = 64 * MiB;
constexpr size_t WS_XB = 73 * MiB;
constexpr size_t ACT_BYTES = (size_t)M * D * 2;
constexpr size_t WS_A = 138 * MiB;
constexpr size_t WS_Y = 316 * MiB;
constexpr size_t WS_SB = 445 * MiB;
constexpr size_t WS_END = WS_SB + ACT_BYTES + 1 * MiB;
static_assert(WS_WD2 + (size_t)D * DFF * 2 <= WS_K && WS_K + (size_t)M * 128 * 2 <= WS_V && WS_V + (size_t)M * 128 * 2 <= WS_XB && WS_XB + ACT_BYTES <= WS_A, "ws map 1");
static_assert(WS_A + (size_t)M * DFF * 2 <= WS_Y && WS_Y + (size_t)M * D * 4 <= WS_SB && WS_END <= 512 * MiB, "ws map 2");
static_assert(WS_W1 + (size_t)NFF2 * D * 2 <= WS_WD1 && WS_WD1 + (size_t)D * DFF * 2 <= WS_WIN && WS_WIN + (size_t)NIN * D * 2 <= WS_WBA && WS_W2 + (size_t)NFF2 * D * 2 <= WS_WD2, "ws map 3");
constexpr int CW_BAR = 1024;

constexpr int RING_OFF = 0, RING_BYTES = 131072;
constexpr int LDSCTL_OFF = RING_BYTES, MISC_OFF = LDSCTL_OFF + 320;
constexpr int LDS_BYTES = 147456;

#define GAS __attribute__((address_space(1)))
#define LAS __attribute__((address_space(3)))
typedef unsigned short bf16;
typedef unsigned v4u __attribute__((ext_vector_type(4)));
typedef unsigned v2u __attribute__((ext_vector_type(2)));
typedef float f32x4 __attribute__((ext_vector_type(4)));
typedef float f32x16 __attribute__((ext_vector_type(16)));
typedef short bf16x8 __attribute__((ext_vector_type(8)));
typedef GAS unsigned gu32;
#define RLX_AGENT __ATOMIC_RELAXED, __HIP_MEMORY_SCOPE_AGENT
#define LDS_WAIT() asm volatile("s_waitcnt lgkmcnt(0)" ::: "memory")
#define VM_WAIT() asm volatile("s_waitcnt vmcnt(0)" ::: "memory")
__device__ __forceinline__ unsigned f2bf(float f) { unsigned u = __builtin_bit_cast(unsigned, f); return (u + 0x7fffu + ((u >> 16) & 1u)) >> 16; }
__device__ __forceinline__ unsigned pk2(float lo, float hi) { return f2bf(lo) | (f2bf(hi) << 16); }
__device__ __forceinline__ float bf2f(unsigned short h) { return __uint_as_float((unsigned)h << 16); }
typedef float f32x2_t __attribute__((ext_vector_type(2))); typedef __bf16 bf16x2_t __attribute__((ext_vector_type(2)));
__device__ __forceinline__ unsigned cvtpk_s(float lo, float hi) { f32x2_t v = {lo, hi}; bf16x2_t b = __builtin_convertvector(v, bf16x2_t); return __builtin_bit_cast(unsigned, b); }

#define XB_TMO      128
#define XB_XCNT(j)  (256  + 64 * (j))
#define XB_XSUB(j)  (1280 + 64 * (j))
#define XB_XGEN(j)  (2304 + 64 * (j))
#define XB_TOP      3328
#define XB_TOPGEN   3392
#define XCD_BAR_WORDS 3456
#define XB_SPIN_CAP (1u << 22)
__device__ __forceinline__ unsigned xb_ld(unsigned* p)              { return __hip_atomic_load(p, __ATOMIC_RELAXED, __HIP_MEMORY_SCOPE_AGENT); }
__device__ __forceinline__ unsigned xb_add(unsigned* p, unsigned v) { return __hip_atomic_fetch_add(p, v, __ATOMIC_RELAXED, __HIP_MEMORY_SCOPE_AGENT); }
__device__ __forceinline__ unsigned xb_xcc_id() { return (unsigned)__builtin_amdgcn_s_getreg((3 << 11) | 20) & 0xFu; }
#define XB_SPIN(cond, bar) do { unsigned _sp = 0; while (cond) { __builtin_amdgcn_s_sleep(1); \
    if ((++_sp & 255u) == 0u) { if (xb_ld(&(bar)[XB_TMO])) break; if (_sp > XB_SPIN_CAP) { atomicAdd(&(bar)[XB_TMO], 1u); break; } } } } while (0)
struct XcdBarrier { unsigned* bar; unsigned x; volatile LAS unsigned* st; };
__device__ __forceinline__ XcdBarrier xcd_barrier_post(unsigned* bar, volatile LAS unsigned* st) {
    XcdBarrier b; b.bar = bar; b.x = xb_xcc_id(); b.st = st;
    if (threadIdx.x == 0) (void)xb_add(&bar[XB_XCNT(b.x)], 1u);
    return b;
}
__device__ __forceinline__ void xcd_barrier_complete(unsigned* bar, unsigned x, unsigned& nloc, unsigned& nx) {
    const unsigned G = gridDim.x * gridDim.y * gridDim.z;
    unsigned sum, cnt, mine, sp = 0u;
    for (;;) {
        sum = 0u; cnt = 0u; mine = 0u;
#pragma unroll
        for (unsigned j = 0; j < 16; ++j) { const unsigned c = xb_ld(&bar[XB_XCNT(j)]); sum += c; cnt += (c > 0u) ? 1u : 0u; mine = (j == x) ? c : mine; }
        if (sum == G) break;
        __builtin_amdgcn_s_sleep(1);
        if ((++sp & 255u) == 0u) { if (xb_ld(&bar[XB_TMO])) break; if (sp > XB_SPIN_CAP) { atomicAdd(&bar[XB_TMO], 1u); break; } }
    }
    nloc = mine > 0u ? mine : 1u; nx = cnt > 0u ? cnt : 1u;
}
__device__ __forceinline__ void xcd_barrier(const XcdBarrier& b) {
    asm volatile("s_waitcnt vmcnt(0)" ::: "memory");
    __syncthreads();
    if (threadIdx.x == 0) {
        unsigned* bar = b.bar;
        __builtin_amdgcn_s_waitcnt(0);
        unsigned nloc = b.st[0], nx = b.st[1];
        if (nloc == 0u) { xcd_barrier_complete(bar, b.x, nloc, nx); b.st[0] = nloc; b.st[1] = nx; }
        const unsigned old = xb_add(&bar[XB_XSUB(b.x)], 1u);
        const unsigned gen = old / nloc;
        if (old + 1u == (gen + 1u) * nloc) {
            __builtin_amdgcn_fence(__ATOMIC_RELEASE, "agent");
            asm volatile("s_waitcnt vmcnt(0)" ::: "memory");
            const unsigned og = xb_add(&bar[XB_TOP], 1u);
            const unsigned tg = og / nx;
            if (og + 1u == (tg + 1u) * nx) xb_add(&bar[XB_TOPGEN], 1u);
            else XB_SPIN(xb_ld(&bar[XB_TOPGEN]) == tg, bar);
            __builtin_amdgcn_fence(__ATOMIC_ACQUIRE, "agent");
            xb_add(&bar[XB_XGEN(b.x)], 1u);
            asm volatile("s_waitcnt vmcnt(0)" ::: "memory");
        } else {
            XB_SPIN(xb_ld(&bar[XB_XGEN(b.x)]) == gen, bar);
            __builtin_amdgcn_fence(__ATOMIC_ACQUIRE, "agent");
            asm volatile("s_waitcnt vmcnt(0)" ::: "memory");
        }
    }
    __syncthreads();
}

struct Frame {
    LAS unsigned char* lds;
    volatile LAS unsigned* MISC;
    gu32* ctl;
    int tid, lane, wave;
    int vcu, G;
    const float* in[21]; float* out; unsigned char* ws;
};
__device__ __forceinline__ float wave_sum(float v) {
#pragma unroll
    for (int o = 1; o < 64; o <<= 1) v += __shfl_xor(v, o);
    return v;
}
__device__ __forceinline__ const float* xrow_src(const Frame& F, int row) { return row < MP ? F.in[0] + (size_t)row * D : F.in[1] + (size_t)(row - MP) * D; }

__device__ __forceinline__ void p0_transpose_item(const float* W, int K, int N, const float* gain, bf16* WT, int mode  , LAS float* scr, int item, int lane) {
    const int nblk = N / 32, kb = item / nblk, nb = item % nblk, k0 = 64 * kb, n0 = 32 * nb;
#pragma unroll 8
    for (int i = 0; i < 32; ++i) { const int kk = 2 * i + (lane >> 5); scr[kk * 33 + (lane & 31)] = W[(size_t)(k0 + kk) * N + n0 + (lane & 31)]; }
    LDS_WAIT(); asm volatile("" ::: "memory");
    const int c = lane & 7;
    float gk[8];
#pragma unroll
    for (int e = 0; e < 8; ++e) gk[e] = gain ? gain[k0 + 8 * c + e] : 1.0f;
    const int rbase = mode == 0 ? n0 : (256 * (n0 >> 7) + (n0 & 127) + (mode == 2 ? 128 : 0));
#pragma unroll
    for (int j = 0; j < 4; ++j) { const int n = (lane >> 3) + 8 * j; const LAS float* s = scr + (8 * c) * 33 + n;
        v4u o; o.x = pk2(s[0 * 33] * gk[0], s[1 * 33] * gk[1]); o.y = pk2(s[2 * 33] * gk[2], s[3 * 33] * gk[3]); o.z = pk2(s[4 * 33] * gk[4], s[5 * 33] * gk[5]); o.w = pk2(s[6 * 33] * gk[6], s[7 * 33] * gk[7]);
        *(GAS v4u*)(WT + (size_t)(rbase + n) * K + k0 + 8 * c) = o; }
    LDS_WAIT(); asm volatile("" ::: "memory");
}
__device__ __forceinline__ int t5_bucket(int rel) {
    const int ret = rel > 0 ? 16 : 0; const int n = rel < 0 ? -rel : rel;
    if (n < 8) return ret + n;
    const int hb = 31 - __builtin_clz((unsigned)(n * n));
    int large = 8 + hb - 6; if (large > 15) large = 15;
    return ret + large;
}
__device__ __forceinline__ void p0_prologue(Frame& F) {
    LAS float* scr = (LAS float*)(F.lds + RING_OFF + F.wave * 16384);
    const int gw = F.vcu * NWAVES + F.wave, NGW = F.G * NWAVES;
    unsigned char* ws = F.ws;
    const float* ng = F.in[5];
    constexpr int I_GU = (D / 64) * (DFF / 32), I_DN = (DFF / 64) * (D / 32), I_IN = (D / 64) * (NIN / 32), I_SQ = (D / 64) * (D / 32);
    constexpr int NITEMS = 4 * I_GU + 2 * I_DN + I_IN + 3 * I_SQ;
    for (int it = gw; it < NITEMS; it += NGW) {
        int r = it;
        if (r < I_GU) { p0_transpose_item(F.in[6], D, DFF, ng + 0 * D, (bf16*)(ws + WS_W1), 1, scr, r, F.lane); continue; } r -= I_GU;
        if (r < I_GU) { p0_transpose_item(F.in[7], D, DFF, ng + 0 * D, (bf16*)(ws + WS_W1), 2, scr, r, F.lane); continue; } r -= I_GU;
        if (r < I_GU) { p0_transpose_item(F.in[18], D, DFF, ng + 4 * D, (bf16*)(ws + WS_W2), 1, scr, r, F.lane); continue; } r -= I_GU;
        if (r < I_GU) { p0_transpose_item(F.in[19], D, DFF, ng + 4 * D, (bf16*)(ws + WS_W2), 2, scr, r, F.lane); continue; } r -= I_GU;
        if (r < I_DN) { p0_transpose_item(F.in[8], DFF, D, nullptr, (bf16*)(ws + WS_WD1), 0, scr, r, F.lane); continue; } r -= I_DN;
        if (r < I_DN) { p0_transpose_item(F.in[20], DFF, D, nullptr, (bf16*)(ws + WS_WD2), 0, scr, r, F.lane); continue; } r -= I_DN;
        if (r < I_IN) { p0_transpose_item(F.in[9], D, NIN, ng + 2 * D, (bf16*)(ws + WS_WIN), 0, scr, r, F.lane); continue; } r -= I_IN;
        if (r < I_SQ) { p0_transpose_item(F.in[15], D, D, nullptr, (bf16*)(ws + WS_WBA), 0, scr, r, F.lane); continue; } r -= I_SQ;
        if (r < I_SQ) { p0_transpose_item(F.in[16], D, D, nullptr, (bf16*)(ws + WS_WBG), 0, scr, r, F.lane); continue; } r -= I_SQ;
        p0_transpose_item(F.in[17], D, D, nullptr, (bf16*)(ws + WS_WO), 0, scr, r, F.lane);
    }
    bf16* XB = (bf16*)(ws + WS_XB); float* rs0 = (float*)(ws + TB_RS0);
    for (int m = gw; m < M; m += NGW) {
        const GAS f32x4* xr = (const GAS f32x4*)xrow_src(F, m) + F.lane;
        f32x4 v[4]; float s = 0.f;
#pragma unroll
        for (int j = 0; j < 4; ++j) { v[j] = xr[64 * j]; s += (v[j].x * v[j].x + v[j].y * v[j].y) + (v[j].z * v[j].z + v[j].w * v[j].w); }
        const float ss = wave_sum(s);
        if (F.lane == 0) rs0[m] = 1.0f / sqrtf(ss * (1.f / D) + EPS);
        GAS unsigned long long* o8 = (GAS unsigned long long*)(XB + (size_t)m * D) + F.lane;
#pragma unroll
        for (int j = 0; j < 4; ++j) o8[64 * j] = (unsigned long long)pk2(v[j].x, v[j].y) | ((unsigned long long)pk2(v[j].z, v[j].w) << 32);
    }
    const int gt = F.vcu * (NWAVES * 64) + F.tid, NGT = F.G * NWAVES * 64;
    float* biasrel = (float*)(ws + TB_BIAS); float* sink2 = (float*)(ws + TB_SINK); bf16* wsb = (bf16*)(ws + TB_WSB);
    for (int i = gt; i < 16 * 256; i += NGT) { const int h = i >> 8, idx = i & 255; const int rel = idx - 191;
        biasrel[i] = idx < 255 ? F.in[4][t5_bucket(rel) * 16 + h] * LOG2E : 0.f; }
    for (int i = gt; i < 16; i += NGT) sink2[i] = F.in[10][i] * LOG2E;
    for (int i = gt; i < 4 * 128 * 128; i += NGT) { const int ii = (i >> 7) & 127, jj = i & 127; const bool keep = (jj >> 6) <= (ii >> 6); wsb[i] = (bf16)f2bf(keep ? F.in[13][i] : 0.f); }
    bf16* kvsk = (bf16*)(ws + WS_KVSK); bf16* kvsv = (bf16*)(ws + WS_KVSV);
    for (int i = gt; i < 16 * 192 * 128; i += NGT) { const int bd = i / (192 * 128), r = (i / 128) % 192, c = i & 127;
        if (r < 128) { kvsk[i] = (bf16)f2bf(F.in[2][((size_t)bd * 128 + r) * 128 + c]); kvsv[i] = (bf16)f2bf(F.in[3][((size_t)bd * 128 + r) * 128 + c]); }
        else if (r >= 144) { kvsk[i] = 0; kvsv[i] = 0; } }
}

__device__ __forceinline__ void row_pass(Frame& F, const float* Y, float coef, const float* gain, bool base_is_input, bool write_xb, float* rs_out) {
    const int gw = F.vcu * NWAVES + F.wave, NGW = F.G * NWAVES;
    bf16* XB = (bf16*)(F.ws + WS_XB);
    f32x4 g[4];
#pragma unroll
    for (int j = 0; j < 4; ++j) g[j] = *((const GAS f32x4*)gain + F.lane + 64 * j);
    for (int m = gw; m < M; m += NGW) {
        const GAS f32x4* yr = (const GAS f32x4*)(Y + (size_t)m * D) + F.lane;
        const GAS f32x4* br = (const GAS f32x4*)(base_is_input ? xrow_src(F, m) : F.out + (size_t)m * D) + F.lane;
        GAS f32x4* orow = (GAS f32x4*)(F.out + (size_t)m * D) + F.lane;
        f32x4 y[4], b[4]; float s = 0.f;
#pragma unroll
        for (int j = 0; j < 4; ++j) { y[j] = yr[64 * j]; b[j] = br[64 * j]; s += (y[j].x * y[j].x + y[j].y * y[j].y) + (y[j].z * y[j].z + y[j].w * y[j].w); }
        const float r = coef / sqrtf(wave_sum(s) * (1.f / D) + EPS);
        float s2 = 0.f;
#pragma unroll
        for (int j = 0; j < 4; ++j) { b[j] = b[j] + y[j] * g[j] * r; orow[64 * j] = b[j]; s2 += (b[j].x * b[j].x + b[j].y * b[j].y) + (b[j].z * b[j].z + b[j].w * b[j].w); }
        if (write_xb) {
            const float ss = wave_sum(s2);
            if (F.lane == 0) rs_out[m] = 1.0f / sqrtf(ss * (1.f / D) + EPS);
            GAS unsigned long long* o8 = (GAS unsigned long long*)(XB + (size_t)m * D) + F.lane;
#pragma unroll
            for (int j = 0; j < 4; ++j) o8[64 * j] = (unsigned long long)pk2(b[j].x, b[j].y) | ((unsigned long long)pk2(b[j].z, b[j].w) << 32);
        }
    }
}
__device__ __forceinline__ void ln_pass(Frame& F) {
    const int gw = F.vcu * NWAVES + F.wave, NGW = F.G * NWAVES;
    bf16* GV = (bf16*)(F.ws + WS_Y);
    f32x4 g[4], bb[4];
#pragma unroll
    for (int j = 0; j < 4; ++j) { g[j] = *((const GAS f32x4*)F.in[11] + F.lane + 64 * j); bb[j] = *((const GAS f32x4*)F.in[12] + F.lane + 64 * j); }
    for (int m = gw; m < M; m += NGW) {
        GAS unsigned long long* p8 = (GAS unsigned long long*)(GV + (size_t)m * D) + F.lane;
        f32x4 v[4]; float s = 0.f;
#pragma unroll
        for (int j = 0; j < 4; ++j) { const unsigned long long w = p8[64 * j]; const unsigned lo = (unsigned)w, hi = (unsigned)(w >> 32);
            v[j] = (f32x4){__uint_as_float(lo << 16), __uint_as_float(lo & 0xffff0000u), __uint_as_float(hi << 16), __uint_as_float(hi & 0xffff0000u)}; s += (v[j].x + v[j].y) + (v[j].z + v[j].w); }
        const float mean = wave_sum(s) * (1.f / D); float s2 = 0.f;
#pragma unroll
        for (int j = 0; j < 4; ++j) { v[j] = v[j] - mean; s2 += (v[j].x * v[j].x + v[j].y * v[j].y) + (v[j].z * v[j].z + v[j].w * v[j].w); }
        const float rstd = 1.f / sqrtf(wave_sum(s2) * (1.f / D) + EPS);
#pragma unroll
        for (int j = 0; j < 4; ++j) { v[j] = v[j] * rstd * g[j] + bb[j]; p8[64 * j] = (unsigned long long)pk2(v[j].x, v[j].y) | ((unsigned long long)pk2(v[j].z, v[j].w) << 32); }
        if (m >= MP) { GAS f32x4* o = (GAS f32x4*)(F.out + O_GV + (size_t)(m - MP) * D) + F.lane;
#pragma unroll
            for (int j = 0; j < 4; ++j) o[64 * j] = v[j]; }
    }
}

__device__ __forceinline__ int crow(int r, int hi) { return (r & 3) + 8 * (r >> 2) + 4 * hi; }
constexpr int AT_KP = 144, AT_VP = 400;
constexpr int AT_K = 0, AT_V = 192 * AT_KP, AT_B = AT_V + 64 * AT_VP, AT_END = AT_B + 8 * 256 * 4;
static_assert(AT_END <= RING_BYTES, "attention LDS");
__device__ __forceinline__ void attn_unit(Frame& F, int unit) {
    const int tid = F.tid, lane = F.lane, w = F.wave, r32 = lane & 31, hi = lane >> 5;
    LAS unsigned char* lds = F.lds + RING_OFF;
    bf16* Q = (bf16*)(F.ws + WS_A);
    const bf16* kbase; const bf16* vbase; int kb0, nkb, nqb, nkeys, qrow0, hk;
    if (unit < 1024) { const int b = unit >> 7, c = (unit >> 1) & 63; hk = unit & 1;
        const long r0 = (long)b * SEQ + 64 * c - 128;
        kbase = (const bf16*)(F.ws + WS_K) + r0 * 128 + hk * 64; vbase = (const bf16*)(F.ws + WS_V) + r0 * 128 + hk * 64;
        kb0 = c == 0 ? 4 : (c == 1 ? 2 : 0); nkb = 6; nqb = 2; nkeys = 192; qrow0 = b * SEQ + 64 * c;
    } else { const int bd = (unit - 1024) >> 1; hk = unit & 1;
        kbase = (const bf16*)(F.ws + WS_KVSK) + (size_t)bd * 192 * 128 + hk * 64; vbase = (const bf16*)(F.ws + WS_KVSV) + (size_t)bd * 192 * 128 + hk * 64;
        kb0 = 0; nkb = 5; nqb = 1; nkeys = 144; qrow0 = MP + bd * 16;
    }
#pragma unroll
    for (int j = 0; j < 3; ++j) { const int p = tid + 512 * j, row = p >> 3, ch = p & 7;
        if (row >= kb0 * 32) {
            const v4u kv = *(const GAS v4u*)(kbase + (long)row * 128 + ch * 8);
            const v4u vv = *(const GAS v4u*)(vbase + (long)row * 128 + ch * 8);
            *(LAS v4u*)(lds + AT_K + row * AT_KP + ch * 16) = kv;
            LAS unsigned short* vt = (LAS unsigned short*)(lds + AT_V + (ch * 8) * AT_VP + row * 2);
            vt[0 * (AT_VP / 2)] = (unsigned short)(vv.x & 0xffffu); vt[1 * (AT_VP / 2)] = (unsigned short)(vv.x >> 16);
            vt[2 * (AT_VP / 2)] = (unsigned short)(vv.y & 0xffffu); vt[3 * (AT_VP / 2)] = (unsigned short)(vv.y >> 16);
            vt[4 * (AT_VP / 2)] = (unsigned short)(vv.z & 0xffffu); vt[5 * (AT_VP / 2)] = (unsigned short)(vv.z >> 16);
            vt[6 * (AT_VP / 2)] = (unsigned short)(vv.w & 0xffffu); vt[7 * (AT_VP / 2)] = (unsigned short)(vv.w >> 16);
        } }
    { const float* biasrel = (const float*)(F.ws + TB_BIAS) + (size_t)hk * 8 * 256; LAS float* bt = (LAS float*)(lds + AT_B);
#pragma unroll
      for (int j = 0; j < 4; ++j) bt[tid + 512 * j] = biasrel[tid + 512 * j]; }
    __syncthreads();
    const int h = hk * 8 + w;
    const float sink2 = ((const float*)(F.ws + TB_SINK))[h];
    const LAS float* bt = (const LAS float*)(lds + AT_B) + w * 256;
    for (int qb = 0; qb < nqb; ++qb) {
        const int ql = 32 * qb + r32;
        int qrow = qrow0 + ql; if (qrow > M - 1) qrow = M - 1;
        const bf16* qp = Q + (size_t)qrow * D + h * 64 + 8 * hi;
        bf16x8 qf[4];
#pragma unroll
        for (int s = 0; s < 4; ++s) qf[s] = *(const GAS bf16x8*)(qp + 16 * s);
        f32x16 sc[6];
        float mx = -3.0e38f;
#pragma unroll
        for (int kb = 0; kb < 6; ++kb) {
            if (kb >= kb0 && kb < nkb) {
                f32x16 a = {};
#pragma unroll
                for (int s = 0; s < 4; ++s) { const bf16x8 kf = *(const LAS bf16x8*)(lds + AT_K + (32 * kb + r32) * AT_KP + (16 * s + 8 * hi) * 2);
                    a = __builtin_amdgcn_mfma_f32_32x32x16_bf16(kf, qf[s], a, 0, 0, 0); }
#pragma unroll
                for (int r = 0; r < 16; ++r) { const int kl = 32 * kb + crow(r, hi); float v = a[r] + bt[kl - ql + 63]; if (kl >= nkeys) v = -3.0e38f; a[r] = v; mx = fmaxf(mx, v); }
                sc[kb] = a;
            } else sc[kb] = (f32x16){};
            __builtin_amdgcn_sched_barrier(0);
        }
        mx = fmaxf(mx, __shfl_xor(mx, 32)); mx = fmaxf(mx, sink2);
        float lsum = 0.f;
#pragma unroll
        for (int kb = 0; kb < 6; ++kb) if (kb >= kb0 && kb < nkb) {
#pragma unroll
            for (int r = 0; r < 16; ++r) { const float p = __builtin_amdgcn_exp2f(sc[kb][r] - mx); sc[kb][r] = p; lsum += p; } }
        lsum += __shfl_xor(lsum, 32); lsum += __builtin_amdgcn_exp2f(sink2 - mx);
        f32x16 o[2]; o[0] = (f32x16){}; o[1] = (f32x16){};
#pragma unroll
        for (int kb = 0; kb < 6; ++kb) if (kb >= kb0 && kb < nkb) {
#pragma unroll
            for (int sp = 0; sp < 2; ++sp) {
                v4u pw; pw.x = cvtpk_s(sc[kb][8 * sp + 0], sc[kb][8 * sp + 1]); pw.y = cvtpk_s(sc[kb][8 * sp + 2], sc[kb][8 * sp + 3]);
                pw.z = cvtpk_s(sc[kb][8 * sp + 4], sc[kb][8 * sp + 5]); pw.w = cvtpk_s(sc[kb][8 * sp + 6], sc[kb][8 * sp + 7]);
                const bf16x8 pf = __builtin_bit_cast(bf16x8, pw);
#pragma unroll
                for (int db = 0; db < 2; ++db) {
                    const LAS unsigned char* vp = lds + AT_V + (32 * db + r32) * AT_VP + (32 * kb + 16 * sp + 4 * hi) * 2;
                    const v2u lo = *(const LAS v2u*)vp, hi2 = *(const LAS v2u*)(vp + 16);
                    v4u vw; vw.x = lo.x; vw.y = lo.y; vw.z = hi2.x; vw.w = hi2.y;
                    o[db] = __builtin_amdgcn_mfma_f32_32x32x16_bf16(__builtin_bit_cast(bf16x8, vw), pf, o[db], 0, 0, 0);
                }
                __builtin_amdgcn_sched_barrier(0); } }
        const float rl = 1.0f / lsum;
        if (qrow0 + ql < M && (nqb == 2 || ql < 16)) {
            bf16* op = Q + (size_t)(qrow0 + ql) * D + h * 64 + 4 * hi;
#pragma unroll
            for (int db = 0; db < 2; ++db)
#pragma unroll
                for (int g4 = 0; g4 < 4; ++g4) { v2u wv; wv.x = cvtpk_s(o[db][4 * g4] * rl, o[db][4 * g4 + 1] * rl); wv.y = cvtpk_s(o[db][4 * g4 + 2] * rl, o[db][4 * g4 + 3] * rl);
                    *(GAS v2u*)(op + 32 * db + 8 * g4) = wv; }
        }
    }
    __syncthreads();
}

constexpr int GT_P = 272;
constexpr int GT_W = 0, GT_V = 128 * GT_P, GT_END = GT_V + 256 * GT_P;
static_assert(GT_END <= RING_BYTES, "gate LDS");
__device__ __forceinline__ void gate_unit(Frame& F, int unit) {
    const int tid = F.tid, lane = F.lane, w = F.wave, r32 = lane & 31, hi = lane >> 5;
    LAS unsigned char* lds = F.lds + RING_OFF;
    bf16* U = (bf16*)(F.ws + WS_A + ACT_BYTES); const bf16* VN = (const bf16*)(F.ws + WS_Y);
    int row0, g, nj, nks, nib;
    if (unit < 1024) { g = unit & 3; row0 = (unit >> 2) * 128; nj = 128; nks = 8; nib = 4; }
    else { g = unit & 3; row0 = MP + ((unit - 1024) >> 2) * 16; nj = 16; nks = 1; nib = 1; }
    const bf16* wsb = (const bf16*)(F.ws + TB_WSB) + (size_t)g * 128 * 128;
#pragma unroll
    for (int j = 0; j < 4; ++j) { const int p = tid + 512 * j, row = p >> 4, ch = p & 15;
        *(LAS v4u*)(lds + GT_W + row * GT_P + ch * 16) = *(const GAS v4u*)(wsb + row * 128 + ch * 8); }
#pragma unroll
    for (int j = 0; j < 8; ++j) { const int p = tid + 512 * j, row = p >> 5, ch = p & 31;
        if (row < nj) {
            const v4u vv = *(const GAS v4u*)(VN + (size_t)(row0 + row) * D + g * 256 + ch * 8);
            LAS unsigned short* vt = (LAS unsigned short*)(lds + GT_V + (ch * 8) * GT_P + row * 2);
            vt[0 * (GT_P / 2)] = (unsigned short)(vv.x & 0xffffu); vt[1 * (GT_P / 2)] = (unsigned short)(vv.x >> 16);
            vt[2 * (GT_P / 2)] = (unsigned short)(vv.y & 0xffffu); vt[3 * (GT_P / 2)] = (unsigned short)(vv.y >> 16);
            vt[4 * (GT_P / 2)] = (unsigned short)(vv.z & 0xffffu); vt[5 * (GT_P / 2)] = (unsigned short)(vv.z >> 16);
            vt[6 * (GT_P / 2)] = (unsigned short)(vv.w & 0xffffu); vt[7 * (GT_P / 2)] = (unsigned short)(vv.w >> 16);
        } }
    __syncthreads();
    const int d0 = 32 * w;
    f32x16 acc[4]; acc[0] = (f32x16){}; acc[1] = (f32x16){}; acc[2] = (f32x16){}; acc[3] = (f32x16){};
#pragma unroll
    for (int ks = 0; ks < 8; ++ks) if (ks < nks) {
        const bf16x8 bfr = *(const LAS bf16x8*)(lds + GT_V + (d0 + r32) * GT_P + (16 * ks + 8 * hi) * 2);
#pragma unroll
        for (int ib = 0; ib < 4; ++ib) if (ib < nib && !(ib < 2 && ks >= 4)) {
            const bf16x8 afr = *(const LAS bf16x8*)(lds + GT_W + (32 * ib + r32) * GT_P + (16 * ks + 8 * hi) * 2);
            acc[ib] = __builtin_amdgcn_mfma_f32_32x32x16_bf16(afr, bfr, acc[ib], 0, 0, 0);
        }
        __builtin_amdgcn_sched_barrier(0); }
    const float* bs = F.in[14] + g * 128;
    const int col = g * 256 + d0 + r32;
#pragma unroll
    for (int ib = 0; ib < 4; ++ib) if (ib < nib) {
#pragma unroll
        for (int r = 0; r < 16; ++r) { const int i = 32 * ib + crow(r, hi);
            if (i < nj) { GAS unsigned short* up = (GAS unsigned short*)(U + (size_t)(row0 + i) * D + col);
                const float uv = bf2f(*up); *up = (unsigned short)f2bf(uv * (acc[ib][r] + bs[i])); } } }
    __syncthreads();
}

struct Args { const float* in[21]; float* out; unsigned char* ws; int ph_lo, ph_hi, li, pad; };
__global__ void __launch_bounds__(NWAVES * 64, 2) fwd_kernel(Args args) {
    extern __shared__ __attribute__((aligned(16))) unsigned char lds[];
    Frame F;
    F.lds = (LAS unsigned char*)lds;
    F.MISC = (volatile LAS unsigned*)(F.lds + MISC_OFF);
    F.tid = threadIdx.x; F.lane = F.tid & 63; F.wave = __builtin_amdgcn_readfirstlane(F.tid >> 6);
    F.G = gridDim.x; { const int bx = blockIdx.x; F.vcu = (F.G % 8 == 0) ? (bx % 8) * (F.G / 8) + bx / 8 : bx; }
    unsigned char* ws = args.ws; F.ws = ws; F.out = args.out;
#pragma unroll
    for (int i = 0; i < 21; ++i) F.in[i] = args.in[i];
    F.ctl = (gu32*)(ws + WS_CTL);
    for (int u = F.tid; u < (LDS_BYTES - LDSCTL_OFF) / 4; u += NWAVES * 64) ((LAS unsigned*)(F.lds + LDSCTL_OFF))[u] = 0u;
    __syncthreads();
    XcdBarrier bar; bar.bar = (unsigned*)(F.ctl + CW_BAR); bar.x = 0; bar.st = nullptr;
    if (N_LAUNCHES != PER_PHASE) bar = xcd_barrier_post((unsigned*)(F.ctl + CW_BAR), F.MISC + 8);
#define GRID_BAR() do { if (N_LAUNCHES != PER_PHASE) xcd_barrier(bar); } while (0)
    const int lo = args.ph_lo, hi = args.ph_hi;
#define IN(k) (lo <= (k) && (k) < hi)
#define BOTH(k) (IN(k) && IN((k) + 1))
    typedef pg8::bf16_t b16;
    float* rs0 = (float*)(ws + TB_RS0); float* rs2 = (float*)(ws + TB_RS2); float* rs4 = (float*)(ws + TB_RS4);
    const float* ng = F.in[5];

    if (IN(0)) { p0_prologue(F); if (BOTH(0)) GRID_BAR(); }
    if (IN(1)) {
        pg8::Gemm g{(const b16*)(ws + WS_XB), (const b16*)(ws + WS_W1), nullptr, nullptr, D}; pg8::StaticOrder<1> S; S.init(M, NFF2, F.G, (int)blockIdx.x);
        pg8::EpiSwiGLU E{(b16*)(ws + WS_A), rs0};
        pg8::gemm_phase(F.lds + RING_OFF, g, S, E);
        if (BOTH(1)) GRID_BAR();
    }
    if (IN(2)) {
        pg8::Gemm g{(const b16*)(ws + WS_A), (const b16*)(ws + WS_WD1), nullptr, nullptr, DFF}; pg8::StaticOrder<1> S; S.init(M, D, F.G, (int)blockIdx.x);
        pg8::EpiF32 E{(float*)(ws + WS_Y), D};
        pg8::gemm_phase(F.lds + RING_OFF, g, S, E);
        if (BOTH(2)) GRID_BAR();
    }
    if (IN(3)) { row_pass(F, (const float*)(ws + WS_Y), 0.5f, ng + 1 * D, true, true, rs2); if (BOTH(3)) GRID_BAR(); }
    if (IN(4)) {
        pg8::Gemm g{(const b16*)(ws + WS_XB), (const b16*)(ws + WS_WIN), nullptr, nullptr, D}; pg8::StaticOrder<1> S; S.init(M, NIN, F.G, (int)blockIdx.x);
        pg8::EpiWin E{(b16*)(ws + WS_A), (b16*)(ws + WS_K), (b16*)(ws + WS_V), (b16*)(ws + WS_A + ACT_BYTES), (b16*)(ws + WS_Y), (b16*)(ws + WS_Y + ACT_BYTES), (b16*)(ws + WS_SB),
                      (b16*)(ws + WS_KVSK), (b16*)(ws + WS_KVSV), rs2, F.out};
        pg8::gemm_phase(F.lds + RING_OFF, g, S, E);
        if (BOTH(4)) GRID_BAR();
    }
    if (IN(5)) { ln_pass(F); if (BOTH(5)) GRID_BAR(); }
    if (IN(6)) {
        for (int u = F.vcu; u < 1056 + 1088; u += F.G) { if (u < 1056) attn_unit(F, u); else gate_unit(F, u - 1056); }
        if (BOTH(6)) GRID_BAR();
    }
    if (IN(7)) {
        pg8::Gemm g{(const b16*)(ws + WS_A), (const b16*)(ws + WS_WBA), (const b16*)(ws + WS_A + ACT_BYTES), (const b16*)(ws + WS_WBG), D}; pg8::StaticOrder<2> S; S.init(M, D, F.G, (int)blockIdx.x);
        pg8::EpiBranch E{(b16*)(ws + WS_Y + ACT_BYTES), (const b16*)(ws + WS_SB)};
        pg8::gemm_phase(F.lds + RING_OFF, g, S, E);
        if (BOTH(7)) GRID_BAR();
    }
    if (IN(8)) {
        pg8::Gemm g{(const b16*)(ws + WS_Y + ACT_BYTES), (const b16*)(ws + WS_WO), nullptr, nullptr, D}; pg8::StaticOrder<1> S; S.init(M, D, F.G, (int)blockIdx.x);
        pg8::EpiF32 E{(float*)(ws + WS_A), D};
        pg8::gemm_phase(F.lds + RING_OFF, g, S, E);
        if (BOTH(8)) GRID_BAR();
    }
    if (IN(9)) { row_pass(F, (const float*)(ws + WS_A), 1.0f, ng + 3 * D, false, true, rs4); if (BOTH(9)) GRID_BAR(); }
    if (IN(10)) {
        pg8::Gemm g{(const b16*)(ws + WS_XB), (const b16*)(ws + WS_W2), nullptr, nullptr, D}; pg8::StaticOrder<1> S; S.init(M, NFF2, F.G, (int)blockIdx.x);
        pg8::EpiSwiGLU E{(b16*)(ws + WS_A), rs4};
        pg8::gemm_phase(F.lds + RING_OFF, g, S, E);
        if (BOTH(10)) GRID_BAR();
    }
    if (IN(11)) {
        pg8::Gemm g{(const b16*)(ws + WS_A), (const b16*)(ws + WS_WD2), nullptr, nullptr, DFF}; pg8::StaticOrder<1> S; S.init(M, D, F.G, (int)blockIdx.x);
        pg8::EpiF32 E{(float*)(ws + WS_Y), D};
        pg8::gemm_phase(F.lds + RING_OFF, g, S, E);
        if (BOTH(11)) GRID_BAR();
    }
    if (IN(12)) { row_pass(F, (const float*)(ws + WS_Y), 0.5f, ng + 5 * D, false, false, nullptr); }
#undef IN
#undef BOTH
}

extern "C" void kernel_launch(void* const* d_in, const int* in_sizes, int n_in, void* d_out, int out_size, void* d_ws, size_t ws_size, hipStream_t stream) {
    static int grid = 0;
    if (grid == 0) {
        if (n_in != 21 || in_sizes[0] != MP * D || (size_t)out_size != O_END || ws_size < WS_END) {
            fprintf(stderr, "kernel_launch: unexpected shapes: n_in %d in0 %d out %d ws %zu (need %zu)\n", n_in, n_in > 0 ? in_sizes[0] : -1, out_size, ws_size, (size_t)WS_END); grid = -1; return; }
        int dev = 0, cus = 0, per_cu = 0;
        if (hipGetDevice(&dev) != hipSuccess || hipDeviceGetAttribute(&cus, hipDeviceAttributeMultiprocessorCount, dev) != hipSuccess) { grid = -1; return; }
        if (hipFuncSetAttribute((const void*)fwd_kernel, hipFuncAttributeMaxDynamicSharedMemorySize, LDS_BYTES) != hipSuccess) { fprintf(stderr, "kernel_launch: hipFuncSetAttribute failed\n"); grid = -1; return; }
        if (hipOccupancyMaxActiveBlocksPerMultiprocessor(&per_cu, (const void*)fwd_kernel, NWAVES * 64, LDS_BYTES) != hipSuccess || per_cu < 1) {
            fprintf(stderr, "kernel_launch: occupancy query says %d blocks per CU\n", per_cu); (void)hipGetLastError(); grid = -1; return; }
        grid = cus;
    }
    if (grid < 0) return;
    (void)hipMemsetAsync((char*)d_ws + WS_CTL, 0, CTL_ZERO_BYTES, stream);
    Args a{};
    for (int i = 0; i < 21; ++i) a.in[i] = (const float*)d_in[i];
    a.out = (float*)d_out; a.ws = (unsigned char*)d_ws;
    for (int li = 0; li < N_LAUNCHES; ++li) {
        a.ph_lo = (N_LAUNCHES == PER_PHASE) ? li : 0; a.ph_hi = (N_LAUNCHES == PER_PHASE) ? li + 1 : PER_PHASE; a.li = li;
        hipLaunchKernelGGL(fwd_kernel, dim3(grid), dim3(NWAVES * 64), LDS_BYTES, stream, a);
        const hipError_t le = hipPeekAtLastError();
        if (le != hipSuccess) { fprintf(stderr, "kernel_launch: launch %d failed: %s\n", li, hipGetErrorName(le)); break; }
    }
}
```
